# Optimizing an MI355X kernel written in HIP

```python
import math
import jax, jax.numpy as jnp
from jax import lax
import numpy as np

D_MODEL = 2048
BATCH = 4
SEQ = 4096
DEPTH = 1

EPS = 1e-6
MLA_HEADS = 8
QK_NOPE_DIM = 128
QK_ROPE_DIM = 64
V_HEAD_DIM = 128
QK_HEAD_DIM = QK_NOPE_DIM + QK_ROPE_DIM
Q_LORA_RANK = 512
KV_LORA_RANK = 512
MLA_WIDTH = MLA_HEADS * V_HEAD_DIM
CONV_GROUPS = 8
CONV_GROUP_DIM = 128
CONV_WIDTH = CONV_GROUPS * CONV_GROUP_DIM
MIX_WIDTH = MLA_WIDTH + CONV_WIDTH
CONV_KERNEL = 3
ROPE_THETA = 10000.0
Q_BLOCK = 128
IN_SPLITS = (Q_LORA_RANK, KV_LORA_RANK, QK_ROPE_DIM, CONV_WIDTH, CONV_WIDTH, CONV_WIDTH)
IN_WIDTH = sum(IN_SPLITS)
D_FF = 5632

kernel_name = "hymba_mla_shortconv_convffn_encoder_block"


def rmsnorm(x, g):
    xf = x.astype(jnp.float32)
    y = xf * lax.rsqrt(jnp.mean(xf * xf, axis=-1, keepdims=True) + EPS)
    return (y * g.astype(jnp.float32)).astype(x.dtype)


def conv3_centred(h, w):
    hp = jnp.pad(h, ((0, 0), (1, 1), (0, 0)))
    return hp[:, :-2] * w[0] + hp[:, 1:-1] * w[1] + hp[:, 2:] * w[2]


def rope_tables(seq, dim, dtype):
    pos = jnp.arange(seq, dtype=jnp.float32)
    inv_freq = 1.0 / (ROPE_THETA ** (jnp.arange(0, dim, 2, dtype=jnp.float32) / dim))
    ang = pos[:, None] * inv_freq[None, :]
    return jnp.cos(ang).astype(dtype), jnp.sin(ang).astype(dtype)


def apply_rope(x, cos, sin):
    half = x.shape[-1] // 2
    x1, x2 = x[..., :half], x[..., half:]
    c = cos[None, :, None, :]
    s = sin[None, :, None, :]
    return jnp.concatenate([x1 * c - x2 * s, x1 * s + x2 * c], axis=-1)


def dense_bidirectional_attention(q, k, v):
    b, s, h, dqk = q.shape
    dv = v.shape[-1]
    nb = s // Q_BLOCK
    scale = 1.0 / math.sqrt(dqk)
    qb = q.reshape(b, nb, Q_BLOCK, h, dqk).transpose(1, 0, 2, 3, 4)

    def one_block(q_blk):
        scores = jnp.einsum('bqhd,bkhd->bhqk', q_blk, k).astype(jnp.float32) * scale
        probs = jax.nn.softmax(scores, axis=-1).astype(v.dtype)
        return jnp.einsum('bhqk,bkhd->bqhd', probs, v)

    out = lax.map(one_block, qb)
    return out.transpose(1, 0, 2, 3, 4).reshape(b, s, h, dv)


def setup_inputs(seed: int = 0) -> dict:
    key = jax.random.key(seed)
    ks = jax.random.split(key, 20)
    f32 = jnp.float32

    def w(k, shape, fan_in):
        return jax.random.normal(k, shape, f32) * (fan_in ** -0.5)

    def gain(k, shape):
        return 1.0 + 0.02 * jax.random.normal(k, shape, f32)

    L = DEPTH
    return {
        "x": jax.random.normal(ks[0], (BATCH, SEQ, D_MODEL), f32),
        "attn_norm_g": gain(ks[1], (L, D_MODEL)),
        "w_in": w(ks[2], (L, D_MODEL, IN_WIDTH), D_MODEL),
        "q_a_norm_g": gain(ks[3], (L, Q_LORA_RANK)),
        "kv_a_norm_g": gain(ks[4], (L, KV_LORA_RANK)),
        "w_q_b": w(ks[5], (L, Q_LORA_RANK, MLA_HEADS * QK_HEAD_DIM), Q_LORA_RANK),
        "w_kv_b": w(ks[6], (L, KV_LORA_RANK, MLA_HEADS * (QK_NOPE_DIM + V_HEAD_DIM)), KV_LORA_RANK),
        "sc_conv_w": w(ks[7], (L, CONV_KERNEL, CONV_WIDTH), CONV_KERNEL),
        "out_norm_attn_g": gain(ks[8], (L, MLA_WIDTH)),
        "out_norm_conv_g": gain(ks[9], (L, CONV_WIDTH)),
        "w_o": w(ks[10], (L, MIX_WIDTH, D_MODEL), MIX_WIDTH),
        "ffn_norm_g": gain(ks[11], (L, D_MODEL)),
        "w_ffn_up": w(ks[12], (L, D_MODEL, 2 * D_FF), D_MODEL),
        "ffn_conv_w": w(ks[13], (L, CONV_KERNEL, 2 * D_FF), CONV_KERNEL),
        "ffn_conv_b": 0.01 * jax.random.normal(ks[14], (L, 2 * D_FF), f32),
        "w_ffn_down": w(ks[15], (L, D_FF, D_MODEL), D_FF),
        "final_norm_g": gain(ks[16], (D_MODEL,)),
    }


def reference(x, attn_norm_g, w_in, q_a_norm_g, kv_a_norm_g, w_q_b, w_kv_b,
              sc_conv_w, out_norm_attn_g, out_norm_conv_g, w_o, ffn_norm_g,
              w_ffn_up, ffn_conv_w, ffn_conv_b, w_ffn_down, final_norm_g):
    b, s, _ = x.shape
    cos, sin = rope_tables(s, QK_ROPE_DIM, x.dtype)
    split_points = list(np.cumsum(IN_SPLITS)[:-1])

    for l in range(DEPTH):
        h = rmsnorm(x, attn_norm_g[l])
        z = h @ w_in[l]
        c_q, c_kv, k_rope, gate_b, gate_c, sc_h = jnp.split(z, split_points, axis=-1)

        q = (rmsnorm(c_q, q_a_norm_g[l]) @ w_q_b[l]).reshape(b, s, MLA_HEADS, QK_HEAD_DIM)
        q = jnp.concatenate([q[..., :QK_NOPE_DIM], apply_rope(q[..., QK_NOPE_DIM:], cos, sin)], axis=-1)
        kv = (rmsnorm(c_kv, kv_a_norm_g[l]) @ w_kv_b[l]).reshape(b, s, MLA_HEADS, QK_NOPE_DIM + V_HEAD_DIM)
        k_nope, v = kv[..., :QK_NOPE_DIM], kv[..., QK_NOPE_DIM:]
        k_pe = apply_rope(k_rope[:, :, None, :], cos, sin)
        k = jnp.concatenate([k_nope, jnp.broadcast_to(k_pe, (b, s, MLA_HEADS, QK_ROPE_DIM))], axis=-1)
        attn = dense_bidirectional_attention(q, k, v).reshape(b, s, MLA_WIDTH)

        y_conv = gate_b * conv3_centred(gate_c * sc_h, sc_conv_w[l])

        merged = jnp.concatenate([rmsnorm(attn, out_norm_attn_g[l]),
                                  rmsnorm(y_conv, out_norm_conv_g[l])], axis=-1)
        x = x + merged @ w_o[l]

        h = rmsnorm(x, ffn_norm_g[l])
        u = conv3_centred(h @ w_ffn_up[l], ffn_conv_w[l]) + ffn_conv_b[l]
        g, val = u[..., :D_FF], u[..., D_FF:]
        x = x + (jax.nn.silu(g) * val) @ w_ffn_down[l]

    return rmsnorm(x, final_norm_g)
```

```cpp
#include <hip/hip_runtime.h>
#include <hip/hip_bf16.h>
#include <cstdio>
#include <cstdint>

#define LAS __attribute__((address_space(3)))
#define GAS __attribute__((address_space(1)))
typedef unsigned short bf16_t;
typedef short bf16x8 __attribute__((ext_vector_type(8)));
typedef short s16x4 __attribute__((ext_vector_type(4)));
typedef float f32x4 __attribute__((ext_vector_type(4)));
typedef float f32x2 __attribute__((ext_vector_type(2)));
typedef float f32x16 __attribute__((ext_vector_type(16)));
typedef unsigned u32x4 __attribute__((ext_vector_type(4)));
typedef unsigned u32x2 __attribute__((ext_vector_type(2)));

constexpr int BATCH = 4, SEQ = 4096, DM = 2048, M = BATCH * SEQ;
constexpr int NH = 8, QLR = 512, CW = 1024, INW = 4160, DFF = 5632;
constexpr float EPS = 1e-6f;
constexpr float QSCALE = 0.07216878364870322f * 1.4426950408889634f;

constexpr size_t MiB = 1u << 20;
constexpr size_t WS_CTL = 0, CTL_ZERO_BYTES = 1 * MiB;
constexpr size_t WS_SSQ1 = 1 * MiB, WS_SSQQ = WS_SSQ1 + 64 * 1024, WS_SSQKV = WS_SSQQ + 512 * 1024, WS_SSQA = WS_SSQKV + 512 * 1024;
constexpr size_t WS_SSQ2 = 3 * MiB, WS_SSQ3 = 5 * MiB, WS_ROPE = 7 * MiB;
constexpr size_t WS_KPE = 9 * MiB, WS_HALO = 11 * MiB;
constexpr size_t WS_WIN = 22 * MiB, WS_WQ = 39 * MiB, WS_WKV = 45 * MiB, WS_WO = 53 * MiB, WS_WUP = 61 * MiB, WS_WD = 105 * MiB;
constexpr size_t WS_XB = 127 * MiB, WS_ZA = 191 * MiB, WS_G = 255 * MiB;
constexpr size_t WS_MERGED = WS_XB;
constexpr size_t WS_A2 = 127 * MiB;
constexpr size_t WS_Q = 351 * MiB, WS_KV = 399 * MiB;
constexpr size_t WS_X1B = WS_Q;
constexpr size_t WS_END = 463 * MiB;
constexpr int WIN_ROWS = 4352;
constexpr int CW_TMO = 0;
constexpr int CW_BAR = 4096;

constexpr int RING_OFF = 0, RING_BYTES = 131072;
constexpr int LDSCTL_OFF = RING_BYTES, MISC_OFF = LDSCTL_OFF + 320;
constexpr int RS_OFF = LDSCTL_OFF + 1024;
constexpr int XR_OFF = RS_OFF + 2048;
constexpr int LDS_BYTES = 147456;
static_assert(XR_OFF + 8192 <= LDS_BYTES, "LDS map");

__device__ __forceinline__ unsigned cvt_pk_bf16(float lo, float hi) { unsigned r; asm volatile("v_cvt_pk_bf16_f32 %0, %1, %2" : "=v"(r) : "v"(lo), "v"(hi)); return r; }
__device__ __forceinline__ float bf_lo(unsigned w) { return __uint_as_float(w << 16); }
__device__ __forceinline__ float bf_hi(unsigned w) { return __uint_as_float(w & 0xffff0000u); }
__device__ __forceinline__ float wave_sum(float v) {
#pragma unroll
    for (int o = 1; o < 64; o <<= 1) v += __shfl_xor(v, o);
    return v;
}
__device__ __forceinline__ float dpp_ror1(float v) { return __builtin_bit_cast(float, __builtin_amdgcn_update_dpp(0, __builtin_bit_cast(int, v), 0x121, 0xf, 0xf, false)); }
__device__ __forceinline__ float dpp_ror15(float v) { return __builtin_bit_cast(float, __builtin_amdgcn_update_dpp(0, __builtin_bit_cast(int, v), 0x12F, 0xf, 0xf, false)); }
__device__ __forceinline__ float silu_mul(float g, float v) { return g * v * __builtin_amdgcn_rcpf(1.0f + __builtin_amdgcn_exp2f(-1.4426950408889634f * g)); }

namespace pg8 {
constexpr int BM = 256, BK = 64, HALF = 128, HTB = HALF * BK * 2, STAGE_BYTES = 8 * HTB, NXCD = 8, WGM = 8;
__host__ __device__ __forceinline__ int lds_byte(int r, int c) { const int st = (r >> 4) * 2 + (c >> 5), rr = r & 15, cc = c & 31, ob = rr * 64 + cc * 2; return st * 1024 + (ob ^ (((ob >> 9) & 1) << 5)); }
__host__ __device__ __forceinline__ void stage_rc(int b, int& R, int& C) { const int st = b / 1024, sb = b % 1024, swz = sb ^ (((sb >> 9) & 1) << 5); R = (st >> 1) * 16 + swz / 64; C = (st & 1) * 32 + (swz % 64) / 2; }
__host__ __device__ __forceinline__ int perm32(int rho) { const int n = rho >> 4, i = rho & 15; return 8 * (i >> 2) + 4 * n + (i & 3); }

struct Unit { int pm, pn, ty; };

struct OrdGrid {
    int nM, nN, nwg, G, c;
    __device__ void init(int M_, int N_, int G_, int c_) { nM = M_ / BM; nN = N_ / BM; nwg = nM * nN; G = G_; c = c_; }
    __device__ bool next(int i, Unit& u) const {
        const long L = (long)i * G + c; if (L >= nwg) return false;
        int wgid = (int)L; { const int q = nwg / NXCD, r = nwg % NXCD, xcd = wgid % NXCD, off = wgid / NXCD; wgid = (xcd < r ? xcd * (q + 1) : r * (q + 1) + (xcd - r) * q) + off; }
        const int nig = WGM * nN, gid = wgid / nig, fm = gid * WGM, gsz = (nM - fm) < WGM ? (nM - fm) : WGM;
        u.pm = fm + ((wgid % nig) % gsz); u.pn = (wgid % nig) / gsz; u.ty = 0; return true;
    }
};
struct OrdP2 {
    int G, c;
    __device__ static void small(int s, Unit& u) { if (s < 384) { u.ty = 0; u.pm = s / 6; u.pn = s % 6; } else { s -= 384; u.ty = 1; u.pm = s >> 3; u.pn = s & 7; } }
    __device__ bool next(int i, Unit& u) const {
        if (G == 256) {
            if (c < 64) { if (i == 0) { u.ty = 2; u.pm = c; u.pn = 0; return true; } if (i == 1) { small(c, u); return true; } return false; }
            const int s = 64 + (c - 64) + 192 * i; if (s >= 896) return false; small(s, u); return true;
        }
        const int L = i * G + c; if (L >= 960) return false;
        if (L < 64) { u.ty = 2; u.pm = L; u.pn = 0; } else small(L - 64, u);
        return true;
    }
};

struct ProbGrid { const bf16_t* A; const bf16_t* Bt; int lda, ldb, ntk;
    __device__ __forceinline__ void ptrs(const Unit& u, const char*& a, const char*& b, int& nt) const {
        a = (const char*)A + (size_t)u.pm * BM * lda * 2; b = (const char*)Bt + (size_t)u.pn * BM * ldb * 2; nt = ntk; } };
struct ProbP2 { const bf16_t* ZA; const bf16_t* XB; const bf16_t* WqT; const bf16_t* WkvT; const bf16_t* WinT; int lda, ldb;
    __device__ __forceinline__ void ptrs(const Unit& u, const char*& a, const char*& b, int& nt) const {
        if (u.ty == 2) { a = (const char*)XB + (size_t)u.pm * BM * lda * 2; b = (const char*)WinT + (size_t)4096 * ldb * 2; nt = 32; }
        else if (u.ty == 0) { a = (const char*)ZA + (size_t)u.pm * BM * lda * 2; b = (const char*)WqT + (size_t)u.pn * BM * ldb * 2; nt = 8; }
        else { a = (const char*)ZA + (size_t)u.pm * BM * lda * 2 + 512 * 2; b = (const char*)WkvT + (size_t)u.pn * BM * ldb * 2; nt = 8; } } };

__device__ __forceinline__ void fill_rs(LAS float* tab, const float* src, int np, float invn) {
    if (threadIdx.x < 256) {
        int tt = threadIdx.x; asm volatile("" : "+v"(tt));
        const float* p = src + (size_t)tt * np; float s = 0.f;
        if (np == 1) s = p[0];
        else for (int k = 0; k < np; k += 4) { const f32x4 v = *(const f32x4*)(p + k); s += (v.x + v.y) + (v.z + v.w); }
        tab[tt] = rsqrtf(s * invn + EPS);
    }
    asm volatile("s_waitcnt lgkmcnt(0)" ::: "memory");
}
#define RS_TAB(lds, slot) ((LAS float*)((lds) + RS_OFF + (slot) * 1024))
#define TROW(ai, m) ((ai) * HALF + wr * 64 + (m) * 16 + fr)
typedef f32x4 Acc[2][2][4][2];

struct EpiZ {
    static constexpr bool PERM = true; static constexpr int MID_T = -1;
    bf16_t* ZA; bf16_t* Gb; float* ssqq; float* ssqkv; const float* ssq1;
    __device__ __forceinline__ void prep(const Unit& u, int slot, LAS unsigned char* lds) const { fill_rs(RS_TAB(lds, slot), ssq1 + (size_t)u.pm * BM, 1, 1.f / 2048.f); }
    __device__ __forceinline__ void mid(Acc&, const Unit&, int, int, int, int, int, LAS unsigned char*) const {}
    __device__ __forceinline__ void operator()(Acc& acc, const Unit& u, int slot, int wr, int wc, int fr, int fq, LAS unsigned char* lds) const {
        const LAS float* RS = RS_TAB(lds, slot);
        const int pn = u.pn; bf16_t* base; int ld, colt; float* sq = nullptr;
        if (pn < 4) { base = ZA; ld = 2048; colt = pn * 256; sq = (pn < 2) ? ssqq : ssqkv; } else { base = Gb; ld = 3072; colt = (pn - 4) * 256; }
#pragma unroll
        for (int ai = 0; ai < 2; ++ai)
#pragma unroll
            for (int m = 0; m < 4; ++m) {
                const int tr = TROW(ai, m); const size_t row = (size_t)u.pm * BM + tr; const float s = RS[tr]; float ss = 0.f;
                bf16_t* rowp = base + row * ld + colt + wc * 32 + 8 * fq;
#pragma unroll
                for (int bj = 0; bj < 2; ++bj) { const f32x4 v0 = acc[ai][bj][m][0] * s, v1 = acc[ai][bj][m][1] * s;
                    ss += (v0[0] * v0[0] + v0[1] * v0[1]) + (v0[2] * v0[2] + v0[3] * v0[3]) + (v1[0] * v1[0] + v1[1] * v1[1]) + (v1[2] * v1[2] + v1[3] * v1[3]);
                    u32x4 w; w.x = cvt_pk_bf16(v0[0], v0[1]); w.y = cvt_pk_bf16(v0[2], v0[3]); w.z = cvt_pk_bf16(v1[0], v1[1]); w.w = cvt_pk_bf16(v1[2], v1[3]);
                    *(u32x4*)(rowp + bj * HALF) = w; }
                if (sq) { ss += __shfl_xor(ss, 16); ss += __shfl_xor(ss, 32); if (fq == 0) sq[row * 8 + (pn & 1) * 4 + wc] = ss; }
            }
    }
};

struct EpiQKV {
    static constexpr bool PERM = true; static constexpr int MID_T = -1;
    bf16_t* Q; bf16_t* KV; bf16_t* KPE; const float* ssqq; const float* ssqkv; const float* ssq1; const float* rope;
    __device__ __forceinline__ void prep(const Unit& u, int slot, LAS unsigned char* lds) const {
        if (u.ty == 0) fill_rs(RS_TAB(lds, slot), ssqq + (size_t)u.pm * BM * 8, 8, 1.f / 512.f);
        else if (u.ty == 1) fill_rs(RS_TAB(lds, slot), ssqkv + (size_t)u.pm * BM * 8, 8, 1.f / 512.f);
        else fill_rs(RS_TAB(lds, slot), ssq1 + (size_t)u.pm * BM, 1, 1.f / 2048.f);
    }
    __device__ __forceinline__ void mid(Acc&, const Unit&, int, int, int, int, int, LAS unsigned char*) const {}
    __device__ __forceinline__ void operator()(Acc& acc, const Unit& u, int slot, int wr, int wc, int fr, int fq, LAS unsigned char* lds) const {
        const LAS float* RS = RS_TAB(lds, slot);
        const int ty = u.ty, pn = u.pn;
#pragma unroll
        for (int ai = 0; ai < 2; ++ai)
#pragma unroll
            for (int m = 0; m < 4; ++m) {
                const int tr = TROW(ai, m); const size_t row = (size_t)u.pm * BM + tr; const float s = RS[tr]; const int pos = (int)(row & (SEQ - 1));
#pragma unroll
                for (int bj = 0; bj < 2; ++bj) {
                    f32x4 v0 = acc[ai][bj][m][0] * s, v1 = acc[ai][bj][m][1] * s;
                    bool rp, st = true; bf16_t* dst;
                    if (ty == 0) { const int blk = 4 * pn + 2 * bj + (wc >> 1); rp = (blk % 3) == 2; dst = Q + row * 1536 + pn * 256 + bj * HALF + wc * 32 + 8 * fq; }
                    else if (ty == 1) { rp = false; dst = KV + row * 2048 + pn * 256 + bj * HALF + wc * 32 + 8 * fq; }
                    else { rp = (bj == 0 && wc < 2); st = rp; dst = KPE + row * 64 + wc * 32 + 8 * fq; }
                    if (rp) {
                        const int i0 = 16 * (wc & 1) + 4 * fq;
                        const f32x4* cs = (const f32x4*)(rope + ((size_t)pos * 32 + i0) * 2);
                        const f32x4 c01 = cs[0], c23 = cs[1];
                        f32x4 r0, r1;
                        r0[0] = v0[0] * c01[0] - v0[1] * c01[1]; r0[1] = v0[0] * c01[1] + v0[1] * c01[0];
                        r0[2] = v0[2] * c01[2] - v0[3] * c01[3]; r0[3] = v0[2] * c01[3] + v0[3] * c01[2];
                        r1[0] = v1[0] * c23[0] - v1[1] * c23[1]; r1[1] = v1[0] * c23[1] + v1[1] * c23[0];
                        r1[2] = v1[2] * c23[2] - v1[3] * c23[3]; r1[3] = v1[2] * c23[3] + v1[3] * c23[2];
                        v0 = r0; v1 = r1;
                    }
                    if (st) { u32x4 w; w.x = cvt_pk_bf16(v0[0], v0[1]); w.y = cvt_pk_bf16(v0[2], v0[3]); w.z = cvt_pk_bf16(v1[0], v1[1]); w.w = cvt_pk_bf16(v1[2], v1[3]);
                        *(u32x4*)dst = w; }
                }
            }
    }
};

struct EpiO {
    static constexpr bool PERM = false; static constexpr int MID_T = 16;
    const float* x; float* x1; bf16_t* x1b; float* ssq2; const float* ssqa;
    __device__ __forceinline__ void prep(const Unit& u, int slot, LAS unsigned char* lds) const { fill_rs(RS_TAB(lds, slot), ssqa + (size_t)u.pm * BM * 8, 8, 1.f / 1024.f); }
    __device__ __forceinline__ void mid(Acc& acc, const Unit&, int slot, int wr, int wc, int fr, int fq, LAS unsigned char* lds) const {
        const LAS float* RS = RS_TAB(lds, slot);
#pragma unroll
        for (int ai = 0; ai < 2; ++ai)
#pragma unroll
            for (int m = 0; m < 4; ++m) { const float s = RS[TROW(ai, m)];
#pragma unroll
                for (int bj = 0; bj < 2; ++bj)
#pragma unroll
                    for (int n = 0; n < 2; ++n) acc[ai][bj][m][n] *= s; }
    }
    __device__ __forceinline__ void operator()(Acc& acc, const Unit& u, int, int wr, int wc, int fr, int fq, LAS unsigned char*) const {
#pragma unroll
        for (int ai = 0; ai < 2; ++ai)
#pragma unroll
            for (int m = 0; m < 4; ++m) {
                const size_t row = (size_t)u.pm * BM + TROW(ai, m); const size_t off = row * DM + u.pn * BM + wc * 32 + 4 * fq; float ss = 0.f;
#pragma unroll
                for (int bj = 0; bj < 2; ++bj)
#pragma unroll
                    for (int n = 0; n < 2; ++n) { const f32x4 o = *(const f32x4*)(x + off + bj * HALF + n * 16) + acc[ai][bj][m][n];
                        *(f32x4*)(x1 + off + bj * HALF + n * 16) = o; ss += (o[0] * o[0] + o[1] * o[1]) + (o[2] * o[2] + o[3] * o[3]);
                        u32x2 w; w.x = cvt_pk_bf16(o[0], o[1]); w.y = cvt_pk_bf16(o[2], o[3]); *(u32x2*)(x1b + off + bj * HALF + n * 16) = w; }
                ss += __shfl_xor(ss, 16); ss += __shfl_xor(ss, 32); if (fq == 0) ssq2[row * 32 + u.pn * 4 + wc] = ss;
                asm volatile("" ::: "memory");
            }
    }
};

struct EpiDown {
    static constexpr bool PERM = false; static constexpr int MID_T = -1;
    float* out; float* ssq3;
    __device__ __forceinline__ void prep(const Unit&, int, LAS unsigned char*) const {}
    __device__ __forceinline__ void mid(Acc&, const Unit&, int, int, int, int, int, LAS unsigned char*) const {}
    __device__ __forceinline__ void operator()(Acc& acc, const Unit& u, int, int wr, int wc, int fr, int fq, LAS unsigned char*) const {
#pragma unroll
        for (int ai = 0; ai < 2; ++ai)
#pragma unroll
            for (int m = 0; m < 4; ++m) {
                const size_t row = (size_t)u.pm * BM + TROW(ai, m); const size_t off = row * DM + u.pn * BM + wc * 32 + 4 * fq; float ss = 0.f;
#pragma unroll
                for (int bj = 0; bj < 2; ++bj)
#pragma unroll
                    for (int n = 0; n < 2; ++n) { const f32x4 o = *(const f32x4*)(out + off + bj * HALF + n * 16) + acc[ai][bj][m][n];
                        *(f32x4*)(out + off + bj * HALF + n * 16) = o; ss += (o[0] * o[0] + o[1] * o[1]) + (o[2] * o[2] + o[3] * o[3]); }
                ss += __shfl_xor(ss, 16); ss += __shfl_xor(ss, 32); if (fq == 0) ssq3[row * 32 + u.pn * 4 + wc] = ss;
                asm volatile("" ::: "memory");
            }
    }
};

struct EpiUp {
    static constexpr bool PERM = true; static constexpr int MID_T = -1;
    bf16_t* A2; float* halo; const float* ssq2; const float* cw; const float* cb;
    __device__ __forceinline__ void prep(const Unit& u, int slot, LAS unsigned char* lds) const { fill_rs(RS_TAB(lds, slot), ssq2 + (size_t)u.pm * BM * 32, 32, 1.f / 2048.f); }
    __device__ __forceinline__ void mid(Acc&, const Unit&, int, int, int, int, int, LAS unsigned char*) const {}
    __device__ __forceinline__ void operator()(Acc& acc, const Unit& u, int slot, int wr, int wc, int fr, int fq, LAS unsigned char* lds) const {
        const LAS float* RS = RS_TAB(lds, slot);
        LAS float* XR = (LAS float*)(lds + XR_OFF);
        const int lcol = wc * 32 + 8 * fq;
#pragma unroll
        for (int ai = 0; ai < 2; ++ai)
#pragma unroll
            for (int m = 0; m < 4; ++m) { const float s = RS[TROW(ai, m)];
#pragma unroll
                for (int bj = 0; bj < 2; ++bj)
#pragma unroll
                    for (int n = 0; n < 2; ++n) acc[ai][bj][m][n] *= s; }
#pragma unroll
        for (int ai = 0; ai < 2; ++ai) { const int blk = 2 * ai + wr;
            if (fr == 0) {
#pragma unroll
                for (int bj = 0; bj < 2; ++bj)
#pragma unroll
                    for (int n = 0; n < 2; ++n) *(LAS f32x4*)(XR + (2 * blk) * 256 + bj * HALF + lcol + 4 * n) = acc[ai][bj][0][n]; }
            if (fr == 15) {
#pragma unroll
                for (int bj = 0; bj < 2; ++bj)
#pragma unroll
                    for (int n = 0; n < 2; ++n) *(LAS f32x4*)(XR + (2 * blk + 1) * 256 + bj * HALF + lcol + 4 * n) = acc[ai][bj][3][n]; }
        }
        { float* hb = halo + (size_t)u.pm * 4 * 11264 + (size_t)u.pn * 256 + lcol;
            if (wr == 0 && fr < 2) {
#pragma unroll
                for (int bj = 0; bj < 2; ++bj)
#pragma unroll
                    for (int n = 0; n < 2; ++n) *(f32x4*)(hb + (size_t)fr * 11264 + bj * HALF + 4 * n) = acc[0][bj][0][n]; }
            if (wr == 1 && fr >= 14) {
#pragma unroll
                for (int bj = 0; bj < 2; ++bj)
#pragma unroll
                    for (int n = 0; n < 2; ++n) *(f32x4*)(hb + (size_t)(fr - 12) * 11264 + bj * HALF + 4 * n) = acc[1][bj][3][n]; }
        }
        asm volatile("s_waitcnt lgkmcnt(0)" ::: "memory"); __builtin_amdgcn_s_barrier(); asm volatile("" ::: "memory");
        const int gcol = u.pn * 128 + lcol;
        u32x2 keep[2][4];
#pragma unroll
        for (int n = 0; n < 2; ++n) {
            f32x4 w0[2], w1[2], w2[2], bb[2];
#pragma unroll
            for (int bj = 0; bj < 2; ++bj) { const int c = bj * DFF + gcol + 4 * n;
                w0[bj] = *(const f32x4*)(cw + c); w1[bj] = *(const f32x4*)(cw + 2 * DFF + c); w2[bj] = *(const f32x4*)(cw + 4 * DFF + c); bb[bj] = *(const f32x4*)(cb + c); }
#pragma unroll
            for (int ai = 0; ai < 2; ++ai) { const int blk = 2 * ai + wr;
                f32x4 hu[2], hd[2];
#pragma unroll
                for (int bj = 0; bj < 2; ++bj) {
                    hu[bj] = (f32x4){0.f, 0.f, 0.f, 0.f}; hd[bj] = (f32x4){0.f, 0.f, 0.f, 0.f};
                    if (blk > 0) hu[bj] = *(const LAS f32x4*)(XR + (2 * blk - 1) * 256 + bj * HALF + lcol + 4 * n);
                    if (blk < 3) hd[bj] = *(const LAS f32x4*)(XR + (2 * blk + 2) * 256 + bj * HALF + lcol + 4 * n); }
#pragma unroll
                for (int m = 0; m < 4; ++m) {
                    f32x4 uu[2];
#pragma unroll
                    for (int bj = 0; bj < 2; ++bj) {
                        const f32x4 cur = acc[ai][bj][m][n];
                        const f32x4 pu = (m > 0) ? acc[ai][bj][m > 0 ? m - 1 : 0][n] : hu[bj];
                        const f32x4 pd = (m < 3) ? acc[ai][bj][m < 3 ? m + 1 : 3][n] : hd[bj];
#pragma unroll
                        for (int e = 0; e < 4; ++e) {
                            const float a = dpp_ror1(cur[e]), b = (m > 0) ? dpp_ror1(pu[e]) : pu[e];
                            const float c = dpp_ror15(cur[e]), d = (m < 3) ? dpp_ror15(pd[e]) : pd[e];
                            const float up = (fr == 0) ? b : a, dn = (fr == 15) ? d : c;
                            uu[bj][e] = w0[bj][e] * up + w1[bj][e] * cur[e] + w2[bj][e] * dn + bb[bj][e];
                        }
                    }
                    f32x4 r;
#pragma unroll
                    for (int e = 0; e < 4; ++e) r[e] = silu_mul(uu[0][e], uu[1][e]);
                    u32x2 w; w.x = cvt_pk_bf16(r[0], r[1]); w.y = cvt_pk_bf16(r[2], r[3]);
                    if (n == 0) keep[ai][m] = w;
                    else {
                        const int tr = TROW(ai, m);
                        if (tr != 0 && tr != 255) { u32x4 o; o.x = keep[ai][m].x; o.y = keep[ai][m].y; o.z = w.x; o.w = w.y;
                            *(u32x4*)(A2 + ((size_t)u.pm * BM + tr) * DFF + gcol) = o; }
                    }
                }
            }
            asm volatile("" ::: "memory");
        }
    }
};

template <class Prob, class Epi, class Sched>
__device__ __forceinline__ void gemm_phase(LAS unsigned char* lds, const Prob& P, const Sched& S, const Epi& E) {
    const int tid = threadIdx.x, wid = __builtin_amdgcn_readfirstlane(tid >> 6), lane = tid & 63, wr = wid >> 2, wc = wid & 3, fr = lane & 15, fq = lane >> 4;
    const int lda = P.lda, ldb = P.ldb;
    unsigned voffA[2], voffB[2];
#pragma unroll
    for (int i = 0; i < 2; ++i) { int R, C; stage_rc(tid * 16 + i * 8192, R, C); const int Rb = Epi::PERM ? ((R & ~31) + perm32(R & 31)) : R;
        voffA[i] = (unsigned)(R * lda + C) * 2u; voffB[i] = (unsigned)(Rb * ldb + C) * 2u; }
    const size_t kstep = (size_t)(BK * 2);
    const size_t hstepA = (size_t)HALF * lda * 2, hstepB = (size_t)HALF * ldb * 2;
    const unsigned ldsw = (unsigned)wid * 1024u;
    const int aoff = lds_byte(wr * 64 + fr, fq * 8), boff = lds_byte(wc * 32 + fr, fq * 8);
#define PG8_SA(b, h) (((b) * 2 + (h)) * HTB)
#define PG8_SB(b, h) ((4 + (b) * 2 + (h)) * HTB)
#define PG8_STAGE(bufoff, gbase, voff) do { _Pragma("unroll") for (int _i = 0; _i < 2; ++_i) \
        __builtin_amdgcn_global_load_lds((const unsigned*)((const char*)(gbase) + (voff)[_i]), (LAS unsigned*)(lds + (bufoff) + ldsw + _i * 8192), 16, 0, 0); } while (0)
#define PG8_LDA(dst, b, h) do { _Pragma("unroll") for (int m = 0; m < 4; ++m) _Pragma("unroll") for (int k = 0; k < 2; ++k) dst[m][k] = *(const LAS bf16x8*)(lds + PG8_SA(b, h) + aoff + m * 2048 + k * 1024); } while (0)
#define PG8_LDB(dst, b, h) do { _Pragma("unroll") for (int n = 0; n < 2; ++n) _Pragma("unroll") for (int k = 0; k < 2; ++k) dst[n][k] = *(const LAS bf16x8*)(lds + PG8_SB(b, h) + boff + n * 2048 + k * 1024); } while (0)
#define PG8_MMA(ai, bj, At, Bt) do { __builtin_amdgcn_s_setprio(1); _Pragma("unroll") for (int m = 0; m < 4; ++m) _Pragma("unroll") for (int n = 0; n < 2; ++n) _Pragma("unroll") for (int k = 0; k < 2; ++k) \
        acc[ai][bj][m][n] = __builtin_amdgcn_mfma_f32_16x16x32_bf16(Bt[n][k], At[m][k], acc[ai][bj][m][n], 0, 0, 0); __builtin_amdgcn_s_setprio(0); } while (0)
#define PG8_WAIT_V(n) asm volatile("s_waitcnt vmcnt(" #n ")" ::: "memory")
#define PG8_WAIT_L(n) asm volatile("s_waitcnt lgkmcnt(" #n ")" ::: "memory")
#define PG8_BAR __builtin_amdgcn_s_barrier()
#define PG8_SCHED __builtin_amdgcn_sched_barrier(0)
    Unit cur, nxt; int ui = 0;
    if (!S.next(0, cur)) return;
    Acc acc;
#pragma unroll
    for (int a = 0; a < 2; ++a)
#pragma unroll
        for (int b = 0; b < 2; ++b)
#pragma unroll
            for (int m = 0; m < 4; ++m)
#pragma unroll
                for (int n = 0; n < 2; ++n) acc[a][b][m][n] = (f32x4){0.f, 0.f, 0.f, 0.f};
    bf16x8 At[4][2], B0[2][2], B1[2][2];
    const char* cA; const char* cB; int nt;
    P.ptrs(cur, cA, cB, nt);
    E.prep(cur, 0, lds);
    PG8_STAGE(PG8_SB(0, 0), cB, voffB); PG8_STAGE(PG8_SB(0, 1), cB + hstepB, voffB); PG8_STAGE(PG8_SA(0, 0), cA, voffA); PG8_STAGE(PG8_SA(0, 1), cA + hstepA, voffA);
    if (wr == 1) PG8_BAR;
    PG8_WAIT_V(2); PG8_BAR;
    PG8_STAGE(PG8_SB(1, 0), cB + kstep, voffB); PG8_STAGE(PG8_SA(1, 0), cA + kstep, voffA); PG8_STAGE(PG8_SB(1, 1), cB + hstepB + kstep, voffB);
    PG8_WAIT_V(6); PG8_BAR;
    for (;;) {
        const bool has_next = S.next(ui + 1, nxt);
        const char* nA = cA; const char* nB = cB; int nnt = nt;
        if (has_next) P.ptrs(nxt, nA, nB, nnt);
        for (int t = 0; t < nt; t += 2) {
            const bool last = (t == nt - 2);
            if (Epi::MID_T >= 0) { if (t == Epi::MID_T) E.mid(acc, cur, ui & 1, wr, wc, fr, fq, lds); }
            const char* a1 = cA + (size_t)(t + 1) * kstep;
            const char* a2 = last ? nA : cA + (size_t)(t + 2) * kstep; const char* b2 = last ? nB : cB + (size_t)(t + 2) * kstep;
            const char* a3 = a2 + kstep; const char* b3 = b2 + kstep;
            PG8_LDB(B0, 0, 0); PG8_LDB(B1, 0, 1); PG8_SCHED; PG8_LDA(At, 0, 0); PG8_STAGE(PG8_SA(1, 1), a1 + hstepA, voffA);
            PG8_WAIT_V(8); PG8_WAIT_L(0); PG8_BAR; PG8_MMA(0, 0, At, B0); PG8_MMA(0, 1, At, B1); PG8_BAR; PG8_SCHED;
            PG8_LDA(At, 0, 1); PG8_STAGE(PG8_SB(0, 0), b2, voffB); PG8_STAGE(PG8_SB(0, 1), b2 + hstepB, voffB); PG8_STAGE(PG8_SA(0, 0), a2, voffA);
            PG8_WAIT_V(8); PG8_WAIT_L(0); PG8_BAR; PG8_MMA(1, 0, At, B0); PG8_MMA(1, 1, At, B1); PG8_BAR; PG8_SCHED;
            PG8_LDB(B0, 1, 0); PG8_LDB(B1, 1, 1); PG8_SCHED; PG8_LDA(At, 1, 0); PG8_STAGE(PG8_SA(0, 1), a2 + hstepA, voffA);
            PG8_WAIT_V(8); PG8_WAIT_L(0); PG8_BAR; PG8_MMA(0, 0, At, B0); PG8_MMA(0, 1, At, B1); PG8_BAR; PG8_SCHED;
            PG8_LDA(At, 1, 1); PG8_STAGE(PG8_SB(1, 0), b3, voffB); PG8_STAGE(PG8_SB(1, 1), b3 + hstepB, voffB); PG8_STAGE(PG8_SA(1, 0), a3, voffA);
            PG8_WAIT_V(8); PG8_WAIT_L(0); PG8_BAR; PG8_MMA(1, 0, At, B0); PG8_MMA(1, 1, At, B1); PG8_BAR; PG8_SCHED;
        }
        if (wr == 0) PG8_BAR;
        E(acc, cur, ui & 1, wr, wc, fr, fq, lds);
        if (!has_next) break;
        E.prep(nxt, (ui + 1) & 1, lds);
#pragma unroll
        for (int a = 0; a < 2; ++a)
#pragma unroll
            for (int b = 0; b < 2; ++b)
#pragma unroll
                for (int m = 0; m < 4; ++m)
#pragma unroll
                    for (int n = 0; n < 2; ++n) acc[a][b][m][n] = (f32x4){0.f, 0.f, 0.f, 0.f};
        cur = nxt; cA = nA; cB = nB; nt = nnt; ++ui;
        if (wr == 1) PG8_BAR;
    }
    PG8_WAIT_V(0);
    PG8_BAR;
#undef PG8_SA
#undef PG8_SB
#undef PG8_STAGE
#undef PG8_LDA
#undef PG8_LDB
#undef PG8_MMA
#undef PG8_WAIT_V
#undef PG8_WAIT_L
#undef PG8_BAR
#undef PG8_SCHED
}
}

namespace att {
constexpr int NW = 8, QBLK = 32, KVBLK = 64, LDQ = 1536, LDKV = 2048, LDKPE = 64, LDO = 2048;
constexpr int SHM_V = KVBLK * 128 * 2, SHM_K = KVBLK * 192 * 2;
constexpr int OFF_V = 0, OFF_K = 2 * SHM_V, OFF_WS = OFF_K + 2 * SHM_K, OFF_QR = OFF_WS + NW * 64 * 4, ATT_LDS = OFF_QR + NW * 4096;
static_assert(ATT_LDS <= RING_BYTES, "attention LDS");
constexpr float THR = 8.f;
#define SBAR() __builtin_amdgcn_sched_barrier(0)
__device__ __forceinline__ int crow(int r, int hi) { return (r & 3) + 8 * (r >> 2) + 4 * hi; }
__device__ __forceinline__ bf16x8 ld8(const bf16_t* p) { return *reinterpret_cast<const bf16x8*>(p); }

__device__ __forceinline__ void partialSM(f32x16& p0, f32x16& p1, float& m_reg, float& mn, float& alpha) {
  float pmax = p0[0];
#pragma unroll
  for (int r = 1; r < 16; ++r) pmax = fmaxf(pmax, p0[r]);
#pragma unroll
  for (int r = 0; r < 16; ++r) pmax = fmaxf(pmax, p1[r]);
  { auto rr = __builtin_amdgcn_permlane32_swap(__float_as_uint(pmax), __float_as_uint(pmax), false, false);
    pmax = fmaxf(__uint_as_float(rr[0]), __uint_as_float(rr[1])); }
  if (__builtin_expect(__all(pmax - m_reg <= THR), 1)) { mn = m_reg; alpha = 1.f; }
  else { mn = fmaxf(m_reg, pmax); alpha = __builtin_amdgcn_exp2f(m_reg - mn); m_reg = mn; }
#pragma unroll
  for (int r = 0; r < 16; ++r) p0[r] = p0[r] - mn;
#pragma unroll
  for (int r = 0; r < 16; ++r) p1[r] = p1[r] - mn;
#pragma unroll
  for (int r = 0; r < 16; ++r) p0[r] = __builtin_amdgcn_exp2f(p0[r]);
}
__device__ __forceinline__ void finishSM(f32x16& p0, f32x16& p1, float alpha, float& l_reg, bf16x8& pa0, bf16x8& pa1, bf16x8& pa2, bf16x8& pa3) {
#pragma unroll
  for (int r = 0; r < 16; ++r) p1[r] = __builtin_amdgcn_exp2f(p1[r]);
  float ps = 0;
#pragma unroll
  for (int r = 0; r < 16; ++r) ps += p0[r];
#pragma unroll
  for (int r = 0; r < 16; ++r) ps += p1[r];
  { auto rr = __builtin_amdgcn_permlane32_swap(__float_as_uint(ps), __float_as_uint(ps), false, false);
    ps = __uint_as_float(rr[0]) + __uint_as_float(rr[1]); }
  l_reg = l_reg * alpha + ps;
#define PK4(P, BASE, OUT) do { unsigned a0 = cvt_pk_bf16(P[BASE + 0], P[BASE + 1]), a1 = cvt_pk_bf16(P[BASE + 2], P[BASE + 3]);   \
    unsigned b0 = cvt_pk_bf16(P[BASE + 4], P[BASE + 5]), b1 = cvt_pk_bf16(P[BASE + 6], P[BASE + 7]);                              \
    auto r0 = __builtin_amdgcn_permlane32_swap(a0, b0, false, false); auto r1 = __builtin_amdgcn_permlane32_swap(a1, b1, false, false); \
    u32x4 w = {r0[0], r1[0], r0[1], r1[1]}; OUT = *reinterpret_cast<bf16x8*>(&w); } while (0)
  PK4(p0, 0, pa0); PK4(p0, 8, pa1); PK4(p1, 0, pa2); PK4(p1, 8, pa3);
#undef PK4
}
__device__ __forceinline__ void qkt(f32x16& p0, f32x16& p1, const LAS unsigned char* Ks, const bf16x8* qr, const LAS unsigned char* Qr, int kro, int ksw, int hi) {
  p0 = f32x16{}; p1 = f32x16{};
#pragma unroll
  for (int d0 = 0; d0 < 12; ++d0) { const int so = ((2 * (d0 & 3) + hi) ^ ksw) << 4;
    const bf16x8 b0 = *reinterpret_cast<const LAS bf16x8*>(Ks + (d0 >> 2) * 8192 + kro + so);
    const bf16x8 b1 = *reinterpret_cast<const LAS bf16x8*>(Ks + (d0 >> 2) * 8192 + 4096 + kro + so);
    const bf16x8 qf = (d0 < 8) ? qr[d0 < 8 ? d0 : 0] : *reinterpret_cast<const LAS bf16x8*>(Qr + kro + so);
    p0 = __builtin_amdgcn_mfma_f32_32x32x16_bf16(b0, qf, p0, 0, 0, 0);
    p1 = __builtin_amdgcn_mfma_f32_32x32x16_bf16(b1, qf, p1, 0, 0, 0); }
}
__device__ __forceinline__ int v_rd_base(int lane) { return ((lane & 3) << 3) | (((lane >> 2) & 3) << 6) | (((lane >> 4) & 1) << 5) | (((lane >> 5) & 1) << 8); }
constexpr int v_rd_off(int d0, int ks, int half) { return d0 * 512 + ks * 4096 + half * 2048; }
template <int OFF> __device__ __forceinline__ s16x4 tr_read(int vb) {
  s16x4 r; asm volatile("ds_read_b64_tr_b16 %0, %1 offset:%2" : "=&v"(r) : "v"(vb), "i"(OFF) : "memory"); return r;
}
template <int D0> __device__ __forceinline__ void pv_one(f32x16& od, int vb, bf16x8 pa0, bf16x8 pa1, bf16x8 pa2, bf16x8 pa3) {
  const s16x4 l0 = tr_read<v_rd_off(D0, 0, 0)>(vb), h0 = tr_read<v_rd_off(D0, 0, 1)>(vb), l1 = tr_read<v_rd_off(D0, 1, 0)>(vb), h1 = tr_read<v_rd_off(D0, 1, 1)>(vb);
  const s16x4 l2 = tr_read<v_rd_off(D0, 2, 0)>(vb), h2 = tr_read<v_rd_off(D0, 2, 1)>(vb), l3 = tr_read<v_rd_off(D0, 3, 0)>(vb), h3 = tr_read<v_rd_off(D0, 3, 1)>(vb);
  asm volatile("s_waitcnt lgkmcnt(0)" ::: "memory"); SBAR();
#define PK(L, H) (bf16x8){L[0], L[1], L[2], L[3], H[0], H[1], H[2], H[3]}
  od = __builtin_amdgcn_mfma_f32_32x32x16_bf16(pa0, PK(l0, h0), od, 0, 0, 0);
  od = __builtin_amdgcn_mfma_f32_32x32x16_bf16(pa1, PK(l1, h1), od, 0, 0, 0);
  od = __builtin_amdgcn_mfma_f32_32x32x16_bf16(pa2, PK(l2, h2), od, 0, 0, 0);
  od = __builtin_amdgcn_mfma_f32_32x32x16_bf16(pa3, PK(l3, h3), od, 0, 0, 0);
#undef PK
}
__device__ __forceinline__ void pv_d0(f32x16* o, int vb, bf16x8 pa0, bf16x8 pa1, bf16x8 pa2, bf16x8 pa3) {
  pv_one<0>(o[0], vb, pa0, pa1, pa2, pa3); pv_one<1>(o[1], vb, pa0, pa1, pa2, pa3); pv_one<2>(o[2], vb, pa0, pa1, pa2, pa3); pv_one<3>(o[3], vb, pa0, pa1, pa2, pa3);
}
__device__ __forceinline__ void glds16(const char* g, LAS unsigned char* l) { __builtin_amdgcn_global_load_lds((const unsigned*)g, (LAS unsigned*)l, 16, 0, 0); }

__device__ __forceinline__ void attn_unit(int b, int h, int qb, const bf16_t* Q, const bf16_t* KV, const bf16_t* KPE, bf16_t* MG, float* ssqa, LAS unsigned char* L) {
  const int tid = threadIdx.x, lane = tid & 63, r32 = lane & 31, hi = lane >> 5; const int wid = __builtin_amdgcn_readfirstlane(tid >> 6);
  LAS unsigned char* Vl = L + OFF_V; LAS unsigned char* Kl = L + OFF_K;
  LAS float* wsf = (LAS float*)(L + OFF_WS) + wid * 64; LAS float* li_l = wsf; LAS float* al_l = wsf + 32;
  LAS unsigned char* Qr = L + OFF_QR + wid * 4096;
  float m_reg = -1e30f, l_reg = 0; f32x16 o[4] = {}; bf16x8 qr[8];
  const size_t rowbase = (size_t)b * SEQ; const int q0 = qb * 256;
  const int kro = r32 * 128, ksw = (r32 >> 1) & 7;
  const int krow = wid * 8 + (lane >> 3), kcl = (lane & 7) ^ ((krow >> 1) & 7);
  const unsigned voffK = (unsigned)(krow * LDKV + kcl * 8) * 2u, voffP = (unsigned)(krow * LDKPE + kcl * 8) * 2u;
  const int vj = (lane >> 2) & 7, vkg = wid >> 1, vk = (vkg >> 1) * 16 + (vj >> 2) * 8 + (vkg & 1) * 4 + (vj & 3), vc = 32 * (2 * (wid & 1) + (lane >> 5)) + (lane & 3) * 8;
  const unsigned voffV = (unsigned)(vk * LDKV + vc) * 2u;
  const char* Kt = (const char*)(KV + rowbase * LDKV + h * 256); const char* Pt = (const char*)(KPE + rowbase * LDKPE);
  constexpr size_t KSTEP = (size_t)KVBLK * LDKV * 2, PSTEP = (size_t)KVBLK * LDKPE * 2;
#define DMA_K(t, bf) do { const char* kb_ = Kt + (size_t)(t) * KSTEP; LAS unsigned char* kd_ = Kl + (bf) * SHM_K + wid * 1024; \
    glds16(kb_ + voffK, kd_); glds16(kb_ + 128 + voffK, kd_ + 8192); glds16(Pt + (size_t)(t) * PSTEP + voffP, kd_ + 16384); } while (0)
#define DMA_V(t, bf) do { const char* vb_ = Kt + 256 + (size_t)(t) * KSTEP; LAS unsigned char* vd_ = Vl + (bf) * SHM_V + wid * 1024; \
    glds16(vb_ + voffV, vd_); glds16(vb_ + (size_t)32 * LDKV * 2 + voffV, vd_ + 8192); } while (0)
#define END_STEP() do { asm volatile("s_waitcnt vmcnt(0)" ::: "memory"); __syncthreads(); } while (0)
  DMA_K(0, 0); DMA_V(0, 0); DMA_K(1, 1);
  const bf16_t* Qw = Q + (rowbase + q0 + wid * QBLK + r32) * LDQ + h * 192 + hi * 8;
#pragma unroll
  for (int d0 = 0; d0 < 8; ++d0) qr[d0] = ld8(Qw + d0 * 16);
#pragma unroll
  for (int dd = 0; dd < 4; ++dd) *reinterpret_cast<LAS bf16x8*>(Qr + kro + (((2 * dd + hi) ^ ksw) << 4)) = ld8(Qw + (8 + dd) * 16);
  const int vb0 = (int)(unsigned)(uintptr_t)Vl + v_rd_base(lane);
#define RESC(a) do { if (__any((a) < 1.f)) { if (hi == 0) al_l[r32] = (a); asm volatile("s_waitcnt lgkmcnt(0)" ::: "memory"); \
    _Pragma("unroll") for (int d = 0; d < 4; ++d) _Pragma("unroll") for (int r = 0; r < 16; ++r) o[d][r] *= al_l[crow(r, hi)]; } } while (0)
  f32x16 pA0, pA1, pB0, pB1; float mnA, mnB, alA, alB; bf16x8 pa0, pa1, pa2, pa3; constexpr int NT = SEQ / KVBLK;
  END_STEP();
  qkt(pA0, pA1, Kl, qr, Qr, kro, ksw, hi); partialSM(pA0, pA1, m_reg, mnA, alA);
  END_STEP(); DMA_K(2, 0); DMA_V(1, 1);
  for (int j = 1; j + 1 < NT; j += 2) {
    SBAR(); qkt(pB0, pB1, Kl + SHM_K, qr, Qr, kro, ksw, hi);
    finishSM(pA0, pA1, alA, l_reg, pa0, pa1, pa2, pa3); SBAR();
    pv_d0(o, vb0, pa0, pa1, pa2, pa3); partialSM(pB0, pB1, m_reg, mnB, alB);
    RESC(alB);
    END_STEP(); DMA_K(j + 2, 1); DMA_V(j + 1, 0);
    SBAR(); qkt(pA0, pA1, Kl, qr, Qr, kro, ksw, hi);
    finishSM(pB0, pB1, alB, l_reg, pa0, pa1, pa2, pa3); SBAR();
    pv_d0(o, vb0 + SHM_V, pa0, pa1, pa2, pa3); partialSM(pA0, pA1, m_reg, mnA, alA);
    RESC(alA);
    END_STEP(); if (j + 3 < NT) DMA_K(j + 3, 0); DMA_V(j + 2, 1);
  }
  SBAR(); qkt(pB0, pB1, Kl + SHM_K, qr, Qr, kro, ksw, hi);
  finishSM(pA0, pA1, alA, l_reg, pa0, pa1, pa2, pa3); SBAR();
  pv_d0(o, vb0, pa0, pa1, pa2, pa3); partialSM(pB0, pB1, m_reg, mnB, alB);
  RESC(alB);
  END_STEP();
  finishSM(pB0, pB1, alB, l_reg, pa0, pa1, pa2, pa3); SBAR();
  pv_d0(o, vb0 + SHM_V, pa0, pa1, pa2, pa3);
  if (hi == 0) li_l[r32] = l_reg; asm volatile("s_waitcnt lgkmcnt(0)" ::: "memory");
  float rli[16];
#pragma unroll
  for (int r = 0; r < 16; ++r) rli[r] = __builtin_amdgcn_rcpf(li_l[crow(r, hi)]);
  __syncthreads();
  { LAS bf16_t* stg = (LAS bf16_t*)(L + wid * 8192);
#pragma unroll
    for (int r = 0; r < 16; ++r) { const int orow = crow(r, hi);
#pragma unroll
      for (int d0 = 0; d0 < 4; ++d0) stg[orow * 128 + d0 * 32 + r32] = (bf16_t)(cvt_pk_bf16(o[d0][r] * rli[r], 0.f) & 0xffffu); }
    asm volatile("s_waitcnt lgkmcnt(0)" ::: "memory");
    int ln2; asm volatile("v_mbcnt_lo_u32_b32 %0, -1, 0\n\tv_mbcnt_hi_u32_b32 %0, -1, %0" : "=v"(ln2));
    const int lrow = ln2 >> 4, ch = ln2 & 15;
#pragma unroll
    for (int i = 0; i < 8; ++i) { const int row = i * 4 + lrow;
      const u32x4 v = *(const LAS u32x4*)(stg + row * 128 + ch * 8);
      float ss = 0.f;
#pragma unroll
      for (int e = 0; e < 4; ++e) { const float a = bf_lo(v[e]), c = bf_hi(v[e]); ss += a * a + c * c; }
      ss += __shfl_xor(ss, 1); ss += __shfl_xor(ss, 2); ss += __shfl_xor(ss, 4); ss += __shfl_xor(ss, 8);
      const size_t grow = rowbase + q0 + wid * QBLK + row;
      *(u32x4*)(MG + grow * LDO + h * 128 + ch * 8) = v;
      if (ch == 0) ssqa[grow * 8 + h] = ss; }
  }
  __syncthreads();
#undef DMA_K
#undef DMA_V
#undef END_STEP
#undef RESC
}
#undef SBAR
}

typedef GAS unsigned gu32;
#define RLX_AGENT __ATOMIC_RELAXED, __HIP_MEMORY_SCOPE_AGENT
#define LDS_WAIT() asm volatile("s_waitcnt lgkmcnt(0)" ::: "memory")
#define VM_WAIT() asm volatile("s_waitcnt vmcnt(0)" ::: "memory")
#define XB_TMO      128
#define XB_XCNT(j)  (256  + 64 * (j))
#define XB_XSUB(j)  (1280 + 64 * (j))
#define XB_XGEN(j)  (2304 + 64 * (j))
#define XB_TOP      3328
#define XB_TOPGEN   3392
#define XCD_BAR_WORDS 3456
#define XB_SPIN_CAP (1u << 18)
__device__ __forceinline__ unsigned xb_ld(unsigned* p)              { return __hip_atomic_load(p, __ATOMIC_RELAXED, __HIP_MEMORY_SCOPE_AGENT); }
__device__ __forceinline__ unsigned xb_add(unsigned* p, unsigned v) { return __hip_atomic_fetch_add(p, v, __ATOMIC_RELAXED, __HIP_MEMORY_SCOPE_AGENT); }
__device__ __forceinline__ unsigned xb_xcc_id() { return (unsigned)__builtin_amdgcn_s_getreg((3 << 11) | 20) & 0xFu; }
#define XB_SPIN(cond, bar) do { unsigned _sp = 0; while (cond) { __builtin_amdgcn_s_sleep(1); \
    if ((++_sp & 255u) == 0u) { if (xb_ld(&(bar)[XB_TMO])) break; if (_sp > XB_SPIN_CAP) { atomicAdd(&(bar)[XB_TMO], 1u); break; } } } } while (0)
struct XcdBarrier { unsigned* bar; unsigned x; volatile LAS unsigned* st; };
__device__ __forceinline__ XcdBarrier xcd_barrier_post(unsigned* bar, volatile LAS unsigned* st) {
    XcdBarrier b; b.bar = bar; b.x = xb_xcc_id(); b.st = st;
    if (threadIdx.x == 0) (void)xb_add(&bar[XB_XCNT(b.x)], 1u);
    return b;
}
__device__ __forceinline__ void xcd_barrier_complete(unsigned* bar, unsigned x, unsigned& nloc, unsigned& nx) {
    const unsigned G = gridDim.x * gridDim.y * gridDim.z;
    unsigned sum, cnt, mine, sp = 0u;
    for (;;) {
        sum = 0u; cnt = 0u; mine = 0u;
#pragma unroll
        for (unsigned j = 0; j < 16; ++j) { const unsigned c = xb_ld(&bar[XB_XCNT(j)]); sum += c; cnt += (c > 0u) ? 1u : 0u; mine = (j == x) ? c : mine; }
        if (sum == G) break;
        __builtin_amdgcn_s_sleep(1);
        if ((++sp & 255u) == 0u) { if (xb_ld(&bar[XB_TMO])) break; if (sp > XB_SPIN_CAP) { atomicAdd(&bar[XB_TMO], 1u); break; } }
    }
    nloc = mine > 0u ? mine : 1u; nx = cnt > 0u ? cnt : 1u;
}
__device__ __forceinline__ void xcd_barrier(const XcdBarrier& b) {
    asm volatile("s_waitcnt vmcnt(0)" ::: "memory");
    __syncthreads();
    if (threadIdx.x == 0) {
        unsigned* bar = b.bar;
        __builtin_amdgcn_s_waitcnt(0);
        unsigned nloc = b.st[0], nx = b.st[1];
        if (nloc == 0u) { xcd_barrier_complete(bar, b.x, nloc, nx); b.st[0] = nloc; b.st[1] = nx; }
        const unsigned old = xb_add(&bar[XB_XSUB(b.x)], 1u);
        const unsigned gen = old / nloc;
        if (old + 1u == (gen + 1u) * nloc) {
            __builtin_amdgcn_fence(__ATOMIC_RELEASE, "agent");
            asm volatile("s_waitcnt vmcnt(0)" ::: "memory");
            const unsigned og = xb_add(&bar[XB_TOP], 1u);
            const unsigned tg = og / nx;
            if (og + 1u == (tg + 1u) * nx) xb_add(&bar[XB_TOPGEN], 1u);
            else XB_SPIN(xb_ld(&bar[XB_TOPGEN]) == tg, bar);
            __builtin_amdgcn_fence(__ATOMIC_ACQUIRE, "agent");
            xb_add(&bar[XB_XGEN(b.x)], 1u);
            asm volatile("s_waitcnt vmcnt(0)" ::: "memory");
        } else {
            XB_SPIN(xb_ld(&bar[XB_XGEN(b.x)]) == gen, bar);
            __builtin_amdgcn_fence(__ATOMIC_ACQUIRE, "agent");
            asm volatile("s_waitcnt vmcnt(0)" ::: "memory");
        }
    }
    __syncthreads();
}

__device__ __forceinline__ unsigned f2bf(float f) { unsigned u = __builtin_bit_cast(unsigned, f); return (u + 0x7fffu + ((u >> 16) & 1u)) >> 16; }
__device__ __forceinline__ unsigned pk2(float lo, float hi) { return f2bf(lo) | (f2bf(hi) << 16); }
template <class F>
__device__ __forceinline__ void p0_item(const float* W, int Nsrc, bf16_t* WT, int ldt, const float* ks, float gs, LAS float* scr, int kb, int nb, int lane, F srccol) {
    const int k0 = 64 * kb, n0 = 32 * nb;
    const int sc = srccol(n0 + (lane & 31));
#pragma unroll 8
    for (int i = 0; i < 32; ++i) { const int kk = 2 * i + (lane >> 5);
        float v = (sc >= 0) ? W[(size_t)(k0 + kk) * Nsrc + sc] : 0.f;
        if (ks) v *= ks[k0 + kk];
        scr[kk * 33 + (lane & 31)] = v * gs; }
    LDS_WAIT(); asm volatile("" ::: "memory");
    const int c = lane & 7;
#pragma unroll
    for (int j = 0; j < 4; ++j) { const int n = (lane >> 3) + 8 * j; const LAS float* s = scr + (8 * c) * 33 + n;
        u32x4 o; o.x = pk2(s[0 * 33], s[1 * 33]); o.y = pk2(s[2 * 33], s[3 * 33]); o.z = pk2(s[4 * 33], s[5 * 33]); o.w = pk2(s[6 * 33], s[7 * 33]);
        *(GAS u32x4*)(WT + (size_t)(n0 + n) * ldt + k0 + 8 * c) = o; }
    LDS_WAIT(); asm volatile("" ::: "memory");
}

struct Args { const float* in[17]; float* out; unsigned char* ws; int ph_lo, ph_hi; };

__global__ void __launch_bounds__(512, 2) hymba_fwd(Args args) {
    extern __shared__ __attribute__((aligned(16))) unsigned char lds_raw[];
    LAS unsigned char* lds = (LAS unsigned char*)lds_raw;
    volatile LAS unsigned* MISC = (volatile LAS unsigned*)(lds + MISC_OFF);
    const int tid = threadIdx.x, lane = tid & 63, wave = __builtin_amdgcn_readfirstlane(tid >> 6);
    const int G = gridDim.x; const int bx = blockIdx.x; const int vcu = (G % 8 == 0) ? (bx % 8) * (G / 8) + bx / 8 : bx;
    unsigned char* ws = args.ws;
    gu32* ctl = (gu32*)(ws + WS_CTL);
    const float* x = args.in[0]; const float* attn_g = args.in[1]; const float* w_in = args.in[2]; const float* qa_g = args.in[3]; const float* kva_g = args.in[4];
    const float* w_qb = args.in[5]; const float* w_kvb = args.in[6]; const float* sc_w = args.in[7]; const float* on_a = args.in[8]; const float* on_c = args.in[9];
    const float* w_o = args.in[10]; const float* ffn_g = args.in[11]; const float* w_up = args.in[12]; const float* f_cw = args.in[13]; const float* f_cb = args.in[14];
    const float* w_dn = args.in[15]; const float* fin_g = args.in[16];
    float* out = args.out;
    float* SSQ1 = (float*)(ws + WS_SSQ1); float* SSQQ = (float*)(ws + WS_SSQQ); float* SSQKV = (float*)(ws + WS_SSQKV); float* SSQA = (float*)(ws + WS_SSQA);
    float* SSQ2 = (float*)(ws + WS_SSQ2); float* SSQ3 = (float*)(ws + WS_SSQ3); float* ROPE = (float*)(ws + WS_ROPE);
    bf16_t* KPE = (bf16_t*)(ws + WS_KPE); float* HALO = (float*)(ws + WS_HALO);
    bf16_t* WinT = (bf16_t*)(ws + WS_WIN); bf16_t* WqT = (bf16_t*)(ws + WS_WQ); bf16_t* WkvT = (bf16_t*)(ws + WS_WKV); bf16_t* WoT = (bf16_t*)(ws + WS_WO);
    bf16_t* WupT = (bf16_t*)(ws + WS_WUP); bf16_t* WdT = (bf16_t*)(ws + WS_WD);
    bf16_t* XB = (bf16_t*)(ws + WS_XB); bf16_t* ZA = (bf16_t*)(ws + WS_ZA); bf16_t* Gb = (bf16_t*)(ws + WS_G); bf16_t* MG = (bf16_t*)(ws + WS_MERGED);
    bf16_t* A2 = (bf16_t*)(ws + WS_A2); bf16_t* Qb = (bf16_t*)(ws + WS_Q); bf16_t* KVb = (bf16_t*)(ws + WS_KV); bf16_t* X1B = (bf16_t*)(ws + WS_X1B);

    for (int u = tid; u < (LDS_BYTES - LDSCTL_OFF) / 4; u += 512) ((LAS unsigned*)(lds + LDSCTL_OFF))[u] = 0u;
    __syncthreads();
    const int lo = args.ph_lo, hi = args.ph_hi;
    const bool one_launch = (hi - lo) > 1;
    XcdBarrier bar; bar.bar = (unsigned*)(ctl + CW_BAR); bar.x = 0; bar.st = nullptr;
    if (one_launch) bar = xcd_barrier_post((unsigned*)(ctl + CW_BAR), MISC + 8);
#define IN(k) (lo <= (k) && (k) < hi)
#define GRID_BAR(k) do { if (IN(k) && IN((k) + 1)) xcd_barrier(bar); } while (0)
    const int gw = vcu * 8 + wave, NGW = G * 8;

    if (IN(0)) {
        LAS float* scr = (LAS float*)(lds + RING_OFF + wave * 16384);
        constexpr int I_IN = 32 * (WIN_ROWS / 32), I_Q = 8 * 48, I_KV = 8 * 64, I_O = 32 * 64, I_UP = 32 * 352, I_DN = 88 * 64;
        constexpr int NITEMS = I_IN + I_Q + I_KV + I_O + I_UP + I_DN;
        for (int it = gw; it < NITEMS; it += NGW) {
            int r = it;
            if (r < I_IN) { const int nblk = WIN_ROWS / 32;
                p0_item(w_in, INW, WinT, 2048, attn_g, 1.f, scr, r / nblk, r % nblk, lane, [](int n) { if (n < 1024) return n; if (n < 4096) return n + 64; if (n < 4160) { const int i = n - 4096; return 1024 + (i >> 1) + 32 * (i & 1); } return -1; });
                continue; } r -= I_IN;
            if (r < I_Q) { p0_item(w_qb, 1536, WqT, 2048, qa_g, QSCALE, scr, r / 48, r % 48, lane, [](int n) { const int hh = n / 192, d = n % 192; if (d < 128) return n; const int i = d - 128; return hh * 192 + 128 + (i >> 1) + 32 * (i & 1); });
                continue; } r -= I_Q;
            if (r < I_KV) { p0_item(w_kvb, 2048, WkvT, 2048, kva_g, 1.f, scr, r / 64, r % 64, lane, [](int n) { return n; }); continue; } r -= I_KV;
            if (r < I_O) { const int kb = r / 64; p0_item(w_o, 2048, WoT, 2048, (kb < 16) ? on_a : (on_c - 1024), 1.f, scr, kb, r % 64, lane, [](int n) { return n; }); continue; } r -= I_O;
            if (r < I_UP) { p0_item(w_up, 2 * DFF, WupT, 2048, ffn_g, 1.f, scr, r / 352, r % 352, lane, [](int n) { const int pn = n >> 8, bj = (n >> 7) & 1, j = n & 127; return bj * DFF + pn * 128 + j; }); continue; } r -= I_UP;
            p0_item(w_dn, 2048, WdT, DFF, (const float*)nullptr, 1.f, scr, r / 64, r % 64, lane, [](int n) { return n; });
        }
        for (int m = gw; m < M; m += NGW) {
            const GAS f32x4* xr = (const GAS f32x4*)(x + (size_t)m * DM) + lane; f32x4 v[8]; float s = 0.f;
#pragma unroll
            for (int j = 0; j < 8; ++j) { v[j] = xr[64 * j]; s += (v[j].x * v[j].x + v[j].y * v[j].y) + (v[j].z * v[j].z + v[j].w * v[j].w); }
            s = wave_sum(s); if (lane == 0) SSQ1[m] = s;
            GAS u32x2* o8 = (GAS u32x2*)(XB + (size_t)m * DM) + lane;
#pragma unroll
            for (int j = 0; j < 8; ++j) { u32x2 w; w.x = pk2(v[j].x, v[j].y); w.y = pk2(v[j].z, v[j].w); o8[64 * j] = w; }
        }
        for (int e = bx * 512 + tid; e < SEQ * 32; e += G * 512) {
            const int pos = e >> 5, i = e & 31;
            const float invf = 1.0f / powf(10000.0f, (float)i * (1.0f / 32.0f));
            const float ang = (float)pos * invf;
            const double rev = (double)ang * 0.15915494309189535; const double fr_ = rev - __builtin_rint(rev);
            const float f = (float)fr_;
            ROPE[2 * e] = __builtin_amdgcn_cosf(f); ROPE[2 * e + 1] = __builtin_amdgcn_sinf(f);
        }
    }
    GRID_BAR(0);

    if (IN(1)) {
        pg8::ProbGrid P{XB, WinT, 2048, 2048, 32}; pg8::OrdGrid S; S.init(M, 4096, G, bx);
        pg8::EpiZ E{ZA, Gb, SSQQ, SSQKV, SSQ1};
        pg8::gemm_phase(lds + RING_OFF, P, S, E);
    }
    GRID_BAR(1);

    if (IN(2)) {
        pg8::ProbP2 P{ZA, XB, WqT, WkvT, WinT, 2048, 2048}; pg8::OrdP2 S{G, bx};
        pg8::EpiQKV E{Qb, KVb, KPE, SSQQ, SSQKV, SSQ1, ROPE};
        pg8::gemm_phase(lds + RING_OFF, P, S, E);
    }
    GRID_BAR(2);

    if (IN(3)) {
        {
            const int col0 = lane * 16;
            f32x4 w0[4], w1[4], w2[4];
#pragma unroll
            for (int q = 0; q < 4; ++q) { w0[q] = *(const f32x4*)(sc_w + col0 + 4 * q); w1[q] = *(const f32x4*)(sc_w + CW + col0 + 4 * q); w2[q] = *(const f32x4*)(sc_w + 2 * CW + col0 + 4 * q); }
            for (int rb = gw; rb < M / 8; rb += NGW) {
                const int row0 = rb * 8, t0 = row0 & (SEQ - 1);
                float prev[16], cur[16], nxt[16];
#define PROD(dst, row) do { const u32x4* gc = (const u32x4*)(Gb + (size_t)(row) * 3072 + 1024 + col0); const u32x4* sh = (const u32x4*)(Gb + (size_t)(row) * 3072 + 2048 + col0); \
    _Pragma("unroll") for (int q = 0; q < 2; ++q) { const u32x4 a = gc[q], b = sh[q]; _Pragma("unroll") for (int e = 0; e < 4; ++e) { dst[q * 8 + 2 * e] = bf_lo(a[e]) * bf_lo(b[e]); dst[q * 8 + 2 * e + 1] = bf_hi(a[e]) * bf_hi(b[e]); } } } while (0)
                if (t0 == 0) {
#pragma unroll
                    for (int e = 0; e < 16; ++e) prev[e] = 0.f; } else PROD(prev, row0 - 1);
                PROD(cur, row0);
                for (int r = 0; r < 8; ++r) {
                    const int row = row0 + r;
                    if (t0 + r == SEQ - 1) {
#pragma unroll
                        for (int e = 0; e < 16; ++e) nxt[e] = 0.f; } else PROD(nxt, row + 1);
                    const u32x4* gbp = (const u32x4*)(Gb + (size_t)row * 3072 + col0);
                    float y[16]; float ss = 0.f;
#pragma unroll
                    for (int q = 0; q < 2; ++q) { const u32x4 a = gbp[q];
#pragma unroll
                        for (int e = 0; e < 4; ++e) {
                            const int i0 = q * 8 + 2 * e, i1 = i0 + 1;
                            const float c0 = w0[i0 >> 2][i0 & 3] * prev[i0] + w1[i0 >> 2][i0 & 3] * cur[i0] + w2[i0 >> 2][i0 & 3] * nxt[i0];
                            const float c1 = w0[i1 >> 2][i1 & 3] * prev[i1] + w1[i1 >> 2][i1 & 3] * cur[i1] + w2[i1 >> 2][i1 & 3] * nxt[i1];
                            y[i0] = bf_lo(a[e]) * c0; y[i1] = bf_hi(a[e]) * c1; ss += y[i0] * y[i0] + y[i1] * y[i1]; } }
                    ss = wave_sum(ss); const float rstd = rsqrtf(ss * (1.f / 1024.f) + EPS);
                    u32x4 o0, o1;
                    o0.x = cvt_pk_bf16(y[0] * rstd, y[1] * rstd); o0.y = cvt_pk_bf16(y[2] * rstd, y[3] * rstd); o0.z = cvt_pk_bf16(y[4] * rstd, y[5] * rstd); o0.w = cvt_pk_bf16(y[6] * rstd, y[7] * rstd);
                    o1.x = cvt_pk_bf16(y[8] * rstd, y[9] * rstd); o1.y = cvt_pk_bf16(y[10] * rstd, y[11] * rstd); o1.z = cvt_pk_bf16(y[12] * rstd, y[13] * rstd); o1.w = cvt_pk_bf16(y[14] * rstd, y[15] * rstd);
                    u32x4* op = (u32x4*)(MG + (size_t)row * DM + 1024 + col0); op[0] = o0; op[1] = o1;
#pragma unroll
                    for (int e = 0; e < 16; ++e) { prev[e] = cur[e]; cur[e] = nxt[e]; }
                }
#undef PROD
            }
        }
        __syncthreads();
        for (int u = vcu; u < BATCH * NH * (SEQ / 256); u += G) {
            const int bh = u >> 4, qb = u & 15;
            att::attn_unit(bh >> 3, bh & 7, qb, Qb, KVb, KPE, MG, SSQA, lds + RING_OFF);
        }
    }
    GRID_BAR(3);

    if (IN(4)) {
        pg8::ProbGrid P{MG, WoT, 2048, 2048, 32}; pg8::OrdGrid S; S.init(M, DM, G, bx);
        pg8::EpiO E{x, out, X1B, SSQ2, SSQA};
        pg8::gemm_phase(lds + RING_OFF, P, S, E);
    }
    GRID_BAR(4);

    if (IN(5)) {
        pg8::ProbGrid P{X1B, WupT, 2048, 2048, 32}; pg8::OrdGrid S; S.init(M, 2 * DFF, G, bx);
        pg8::EpiUp E{A2, HALO, SSQ2, f_cw, f_cb};
        pg8::gemm_phase(lds + RING_OFF, P, S, E);
    }
    GRID_BAR(5);

    if (IN(6)) {
        for (int it = gw; it < 64 * 22; it += NGW) {
            const int pm = it / 22, rem = it % 22, which = rem / 11, ch = rem % 11;
            const int j0 = ch * 512 + lane * 8, pn = j0 >> 7, jl = j0 & 127, hcol = pn * 256 + jl;
            const float* Hc = HALO + (size_t)pm * 4 * 11264;
            const float *pu, *pc, *pd; int trow;
            if (which == 0) { pu = (pm & 15) ? Hc - 11264 : nullptr; pc = Hc; pd = Hc + 11264; trow = 0; }
            else { pu = Hc + 2 * 11264; pc = Hc + 3 * 11264; pd = ((pm & 15) != 15) ? Hc + 4 * 11264 : nullptr; trow = 255; }
            float uu[2][8];
#pragma unroll
            for (int gv = 0; gv < 2; ++gv) {
                const int hc = hcol + 128 * gv, wcn = gv * DFF + j0;
#pragma unroll
                for (int q = 0; q < 2; ++q) {
                    const f32x4 z = (f32x4){0.f, 0.f, 0.f, 0.f};
                    const f32x4 a = pu ? *(const f32x4*)(pu + hc + 4 * q) : z, b = *(const f32x4*)(pc + hc + 4 * q), c = pd ? *(const f32x4*)(pd + hc + 4 * q) : z;
                    const f32x4 k0 = *(const f32x4*)(f_cw + wcn + 4 * q), k1 = *(const f32x4*)(f_cw + 2 * DFF + wcn + 4 * q), k2 = *(const f32x4*)(f_cw + 4 * DFF + wcn + 4 * q), bb = *(const f32x4*)(f_cb + wcn + 4 * q);
#pragma unroll
                    for (int e = 0; e < 4; ++e) uu[gv][4 * q + e] = k0[e] * a[e] + k1[e] * b[e] + k2[e] * c[e] + bb[e];
                }
            }
            float r[8];
#pragma unroll
            for (int e = 0; e < 8; ++e) r[e] = silu_mul(uu[0][e], uu[1][e]);
            u32x4 o; o.x = cvt_pk_bf16(r[0], r[1]); o.y = cvt_pk_bf16(r[2], r[3]); o.z = cvt_pk_bf16(r[4], r[5]); o.w = cvt_pk_bf16(r[6], r[7]);
            *(u32x4*)(A2 + ((size_t)pm * 256 + trow) * DFF + j0) = o;
        }
    }
    GRID_BAR(6);

    if (IN(7)) {
        pg8::ProbGrid P{A2, WdT, DFF, DFF, 88}; pg8::OrdGrid S; S.init(M, DM, G, bx);
        pg8::EpiDown E{out, SSQ3};
        pg8::gemm_phase(lds + RING_OFF, P, S, E);
    }
    GRID_BAR(7);

    if (IN(8)) {
        for (int m = gw; m < M; m += NGW) {
            float s = (lane < 32) ? SSQ3[(size_t)m * 32 + lane] : 0.f; s = wave_sum(s);
            const float rstd = rsqrtf(s * (1.f / 2048.f) + EPS);
            f32x4* o4 = (f32x4*)(out + (size_t)m * DM) + lane; const f32x4* g4 = (const f32x4*)fin_g + lane;
#pragma unroll
            for (int j = 0; j < 8; ++j) { const f32x4 v = o4[64 * j]; const f32x4 g = g4[64 * j]; o4[64 * j] = v * rstd * g; }
        }
    }
#undef IN
#undef GRID_BAR
}

#ifndef MK_N_LAUNCHES
#define MK_N_LAUNCHES 1
#endif
constexpr int N_PHASES = 9;
extern "C" void kernel_launch(void* const* d_in, const int* in_sizes, int n_in, void* d_out, int out_size, void* d_ws, size_t ws_size, hipStream_t stream) {
    static int grid = 0;
    if (grid == 0) {
        if (n_in != 17 || in_sizes[0] != M * DM || out_size != M * DM || ws_size < WS_END) {
            fprintf(stderr, "kernel_launch: built for 17 inputs, x/out of %d floats, >= %zu bytes of workspace; got n_in %d, in0 %d, out %d, ws %zu; nothing launched\n", M * DM, (size_t)WS_END, n_in, n_in > 0 ? in_sizes[0] : -1, out_size, ws_size);
            grid = -1; return; }
        int dev = 0, cus = 0, per_cu = 0;
        if (hipGetDevice(&dev) != hipSuccess || hipDeviceGetAttribute(&cus, hipDeviceAttributeMultiprocessorCount, dev) != hipSuccess) { grid = -1; return; }
        if (hipFuncSetAttribute((const void*)hymba_fwd, hipFuncAttributeMaxDynamicSharedMemorySize, LDS_BYTES) != hipSuccess) { fprintf(stderr, "kernel_launch: hipFuncSetAttribute failed\n"); grid = -1; return; }
        if (hipOccupancyMaxActiveBlocksPerMultiprocessor(&per_cu, (const void*)hymba_fwd, 512, LDS_BYTES) != hipSuccess || per_cu < 1)
            fprintf(stderr, "kernel_launch: note: occupancy query reports %d workgroups per CU\n", per_cu);
        (void)hipGetLastError();
        grid = cus;
    }
    if (grid < 0) return;
    if (hipMemsetAsync((char*)d_ws + WS_CTL, 0, CTL_ZERO_BYTES, stream) != hipSuccess) { fprintf(stderr, "kernel_launch: memset failed\n"); return; }
    Args a{};
    for (int i = 0; i < 17; ++i) a.in[i] = (const float*)d_in[i];
    a.out = (float*)d_out; a.ws = (unsigned char*)d_ws;
    if (MK_N_LAUNCHES == 1) {
        a.ph_lo = 0; a.ph_hi = N_PHASES;
        hipLaunchKernelGGL(hymba_fwd, dim3(grid), dim3(512), LDS_BYTES, stream, a);
    } else {
        for (int p = 0; p < N_PHASES; ++p) { a.ph_lo = p; a.ph_hi = p + 1; hipLaunchKernelGGL(hymba_fwd, dim3(grid), dim3(512), LDS_BYTES, stream, a); }
    }
    const hipError_t le = hipPeekAtLastError();
    if (le != hipSuccess) fprintf(stderr, "kernel_launch: launch failed: %s\n", hipGetErrorName(le));
}
```
